# Optimizing an MI355X kernel written in HIP

```python
import math
import jax, jax.numpy as jnp
from jax import lax
import numpy as np


D_MODEL = 1024
BATCH = 32
SEQ = 2048
DEPTH = 1

NORM_EPS = 1e-6
HG_HEADS = 4
HG_DK = 128
HG_DV = 128
HG_QK = HG_HEADS * HG_DK
HG_WIDTH = HG_HEADS * HG_DV
HG_CHUNK = 32
NSA_HEADS = 8
NSA_KV_HEADS = 2
NSA_GROUP = NSA_HEADS // NSA_KV_HEADS
NSA_HD = 64
NSA_WIDTH = NSA_HEADS * NSA_HD
NSA_KV_WIDTH = NSA_KV_HEADS * NSA_HD
NSA_BRANCHES = 3
CMP_BLOCK = 32
CMP_STRIDE = 16
CMP_HIDDEN = 4 * NSA_HD
SLC_BLOCK = 64
SLC_TOPK = 16
WINDOW = 512
WIN_Q_BLOCK = 128
SLC_Q_BLOCK = 16
ROT_DIM = NSA_HD // 4
ROPE_THETA = 500000.0
MIX_WIDTH = HG_WIDTH + NSA_WIDTH
IN_SEGMENTS = (HG_QK, HG_QK, HG_WIDTH, HG_WIDTH, NSA_WIDTH) + (NSA_KV_WIDTH,) * 6 + (NSA_HEADS * NSA_BRANCHES,)
IN_WIDTH = sum(IN_SEGMENTS)
PEER_HEADS = 8
PEER_NKEYS = 128
PEER_EXPERTS = PEER_NKEYS * PEER_NKEYS
PEER_TOPK = 16
PEER_DK = 256
PEER_CHUNK = 128

kernel_name = 'hybrid_hgrn2_nsa_peer'


def rms_norm(x, w):
    x = x.astype(jnp.float32)
    return x * lax.rsqrt(jnp.mean(x * x, axis=-1, keepdims=True) + NORM_EPS) * w.astype(jnp.float32)


def masked_softmax(s, mask):
    s = jnp.where(mask, s.astype(jnp.float32), -jnp.inf)
    m = jnp.max(s, axis=-1, keepdims=True)
    m = jnp.where(jnp.isfinite(m), m, 0.0)
    e = jnp.where(mask, jnp.exp(s - m), 0.0)
    return e / jnp.maximum(jnp.sum(e, axis=-1, keepdims=True), jnp.finfo(jnp.float32).tiny)


def rope_tables(pos):
    inv = ROPE_THETA ** (-jnp.arange(0, ROT_DIM, 2, dtype=jnp.float32) / ROT_DIM)
    ang = pos.astype(jnp.float32)[..., None] * inv
    return jnp.cos(ang), jnp.sin(ang)


def partial_rope(x, cos, sin):
    half = ROT_DIM // 2
    x1, x2, rest = x[..., :half], x[..., half:ROT_DIM], x[..., ROT_DIM:]
    return jnp.concatenate([x1 * cos - x2 * sin, x2 * cos + x1 * sin, rest], axis=-1)


def hgrn2_mixer(q, f_raw, i_in, g, lb, out_norm_w):
    B, S, _ = q.shape
    H, C = HG_HEADS, HG_CHUNK
    n = S // C
    f = lb + (1.0 - lb) * jax.nn.sigmoid(f_raw)
    log_f = jnp.log(f)
    k = 1.0 - f

    def chunks(t, d):
        return t.reshape(B, n, C, H, d).transpose(1, 0, 3, 2, 4)

    qc, kc, vc = chunks(q, HG_DK), chunks(k, HG_DK), chunks(i_in, HG_DV)
    bc = jnp.cumsum(chunks(log_f, HG_DK), axis=3)
    causal = jnp.tril(jnp.ones((C, C), dtype=bool))[:, :, None]

    def step(state, inp):
        q_, k_, v_, b_ = inp
        o_inter = jnp.einsum('bhtk,bhkv->bhtv', q_ * jnp.exp(b_), state)
        decay = jnp.exp(jnp.where(causal, b_[:, :, :, None, :] - b_[:, :, None, :, :], -jnp.inf))
        scores = jnp.einsum('bhtk,bhsk,bhtsk->bhts', q_, k_, decay)
        o_intra = jnp.einsum('bhts,bhsv->bhtv', scores, v_)
        b_end = b_[:, :, -1:, :]
        state = jnp.exp(b_end[:, :, 0, :, None]) * state + jnp.einsum('bhsk,bhsv->bhkv', k_ * jnp.exp(b_end - b_), v_)
        return state, o_inter + o_intra

    state0 = jnp.zeros((B, H, HG_DK, HG_DV), jnp.float32)
    _, o = lax.scan(step, state0, (qc, kc, vc, bc))
    o = o.transpose(1, 0, 3, 2, 4).reshape(B, S, H, HG_DV)
    gate = jax.nn.silu(g).reshape(B, S, H, HG_DV)
    return (rms_norm(o, out_norm_w) * gate).reshape(B, S, HG_WIDTH)


def slc_importance_map(n_c, n_s):
    c0 = np.arange(n_c)[:, None] * CMP_STRIDE
    j0 = np.arange(n_s)[None, :] * SLC_BLOCK
    ov = np.clip(np.minimum(c0 + CMP_BLOCK, j0 + SLC_BLOCK) - np.maximum(c0, j0), 0, None)
    return jnp.asarray(ov / CMP_BLOCK, dtype=jnp.float32)


def nsa_mixer(q, kc, vc, ks, vs, kw, vw, gate_raw, positions, q_norm_w, k_norm_w,
              pe_k, pe_v, w1_k, w2_k, w1_v, w2_v, out_norm_w):
    B, S, _ = q.shape
    G, R, Hd = NSA_KV_HEADS, NSA_GROUP, NSA_HD
    cos, sin = rope_tables(positions)
    q = rms_norm(q.reshape(B, S, G, R, Hd).transpose(0, 2, 3, 1, 4), q_norm_w)
    q = partial_rope(q, cos[:, None, None], sin[:, None, None]) * (Hd ** -0.5)

    def kv_heads(t):
        return t.reshape(B, S, G, Hd).transpose(0, 2, 1, 3)

    def token_keys(t, w):
        return partial_rope(rms_norm(kv_heads(t), w), cos[:, None], sin[:, None])

    t_idx = jnp.arange(S)

    n_c = (S - CMP_BLOCK) // CMP_STRIDE + 1
    ends = np.arange(n_c) * CMP_STRIDE + CMP_BLOCK - 1
    blk_idx = ends[:, None] - (CMP_BLOCK - 1) + np.arange(CMP_BLOCK)[None, :]

    def compress(t, pe, w1, w2):
        blocks = kv_heads(t)[:, :, blk_idx] + pe
        return jax.nn.gelu(blocks.reshape(B, G, n_c, CMP_BLOCK * Hd) @ w1) @ w2

    cos_c, sin_c = rope_tables(positions[:, ends])
    k_cmp = partial_rope(rms_norm(compress(kc, pe_k, w1_k, w2_k), k_norm_w[0]), cos_c[:, None], sin_c[:, None])
    v_cmp = compress(vc, pe_v, w1_v, w2_v)
    mask_c = jnp.asarray(ends)[None, :] <= t_idx[:, None]
    p_cmp = masked_softmax(jnp.einsum('bgrtd,bgcd->bgrtc', q, k_cmp), mask_c)
    o_cmp = jnp.einsum('bgrtc,bgcd->bgrtd', p_cmp, v_cmp)

    n_s = S // SLC_BLOCK
    n_sel = min(SLC_TOPK, n_s)
    imp = jnp.einsum('bgrtc,cj->bgtj', p_cmp, slc_importance_map(n_c, n_s))
    blk = jnp.arange(n_s)[None, :]
    cur = (t_idx // SLC_BLOCK)[:, None]
    forced = (blk == 0) | (blk == cur) | (blk == cur - 1)
    score = jnp.where(forced, jnp.inf, jnp.where(blk <= cur, imp, -jnp.inf))
    _, sel = lax.top_k(score, n_sel)
    k_blocks = token_keys(ks, k_norm_w[1]).reshape(B, G, n_s, SLC_BLOCK, Hd)
    v_blocks = kv_heads(vs).reshape(B, G, n_s, SLC_BLOCK, Hd)
    b_ix = jnp.arange(B)[:, None, None, None]
    g_ix = jnp.arange(G)[None, :, None, None]

    def slc_block(args):
        qb, ib, t0 = args
        k_sel = k_blocks[b_ix, g_ix, ib]
        v_sel = v_blocks[b_ix, g_ix, ib]
        s = jnp.einsum('bgrqd,bgqnld->bgrqnl', qb, k_sel).reshape(B, G, R, SLC_Q_BLOCK, n_sel * SLC_BLOCK)
        tok = (ib[..., None] * SLC_BLOCK + jnp.arange(SLC_BLOCK)).reshape(B, G, SLC_Q_BLOCK, n_sel * SLC_BLOCK)
        mask = (tok <= (t0 + jnp.arange(SLC_Q_BLOCK))[:, None])[:, :, None]
        p = masked_softmax(s, mask).reshape(B, G, R, SLC_Q_BLOCK, n_sel, SLC_BLOCK)
        return jnp.einsum('bgrqnl,bgqnld->bgrqd', p, v_sel)

    n_qs = S // SLC_Q_BLOCK
    o_slc = lax.map(slc_block, (jnp.moveaxis(q.reshape(B, G, R, n_qs, SLC_Q_BLOCK, Hd), 3, 0),
                                jnp.moveaxis(sel.reshape(B, G, n_qs, SLC_Q_BLOCK, n_sel), 2, 0),
                                jnp.arange(n_qs) * SLC_Q_BLOCK))
    o_slc = jnp.moveaxis(o_slc, 0, 3).reshape(B, G, R, S, Hd)

    pad = ((0, 0), (0, 0), (WINDOW, 0), (0, 0))
    k_win = jnp.pad(token_keys(kw, k_norm_w[2]), pad)
    v_win = jnp.pad(kv_heads(vw), pad)
    span = WINDOW + WIN_Q_BLOCK

    def win_block(args):
        qb, t0 = args
        kb = lax.dynamic_slice_in_dim(k_win, t0, span, axis=2)
        vb = lax.dynamic_slice_in_dim(v_win, t0, span, axis=2)
        tq = (t0 + jnp.arange(WIN_Q_BLOCK))[:, None]
        sk = (t0 - WINDOW + jnp.arange(span))[None, :]
        mask = (sk >= 0) & (sk <= tq) & (tq - sk < WINDOW)
        p = masked_softmax(jnp.einsum('bgrqd,bgkd->bgrqk', qb, kb), mask)
        return jnp.einsum('bgrqk,bgkd->bgrqd', p, vb)

    n_qw = S // WIN_Q_BLOCK
    o_win = lax.map(win_block, (jnp.moveaxis(q.reshape(B, G, R, n_qw, WIN_Q_BLOCK, Hd), 3, 0),
                                jnp.arange(n_qw) * WIN_Q_BLOCK))
    o_win = jnp.moveaxis(o_win, 0, 3).reshape(B, G, R, S, Hd)

    gates = jax.nn.sigmoid(gate_raw).reshape(B, S, G, R, NSA_BRANCHES).transpose(0, 2, 3, 1, 4)[..., None]
    o = gates[..., 0, :] * o_cmp + gates[..., 1, :] * o_slc + gates[..., 2, :] * o_win
    o = rms_norm(o, out_norm_w)
    return o.transpose(0, 3, 1, 2, 4).reshape(B, S, NSA_WIDTH)


def peer_ffn(h, w_q, sub_keys, u_tab, v_tab):
    B, S, D = h.shape
    half = PEER_DK // 2

    def chunk(xc):
        q = (xc @ w_q).reshape(PEER_CHUNK, PEER_HEADS, 2, half)
        s1 = jnp.einsum('thd,nd->thn', q[:, :, 0], sub_keys[0])
        s2 = jnp.einsum('thd,nd->thn', q[:, :, 1], sub_keys[1])
        v1, i1 = lax.top_k(s1, PEER_TOPK)
        v2, i2 = lax.top_k(s2, PEER_TOPK)
        cand_s = (v1[..., :, None] + v2[..., None, :]).reshape(PEER_CHUNK, PEER_HEADS, PEER_TOPK * PEER_TOPK)
        cand_i = (i1[..., :, None] * PEER_NKEYS + i2[..., None, :]).reshape(PEER_CHUNK, PEER_HEADS, PEER_TOPK * PEER_TOPK)
        top_s, pos = lax.top_k(cand_s, PEER_TOPK)
        e_idx = jnp.take_along_axis(cand_i, pos, axis=-1)
        gate = jax.nn.softmax(top_s.astype(jnp.float32), axis=-1)
        act = jax.nn.gelu(jnp.einsum('tpkd,td->tpk', u_tab[e_idx], xc), approximate=False) * gate
        return jnp.einsum('tpk,tpkd->td', act, v_tab[e_idx])

    return lax.map(chunk, h.reshape(-1, PEER_CHUNK, D)).reshape(B, S, D)


def setup_inputs(seed: int = 0) -> dict:
    key = jax.random.key(seed)
    ks = jax.random.split(key, 24)
    nrm = lambda k, shape, scale: jax.random.normal(k, shape, jnp.float32) * scale
    gain = lambda k, shape: 1.0 + 0.05 * jax.random.normal(k, shape, jnp.float32)
    x = jax.random.normal(ks[0], (BATCH, SEQ, D_MODEL), jnp.float32)
    positions = jnp.arange(SEQ, dtype=jnp.int32)[None, :] + jax.random.randint(ks[1], (BATCH, 1), 0, 4096, dtype=jnp.int32)
    return {
        'x': x,
        'positions': positions,
        'norm1_w': gain(ks[2], (DEPTH, D_MODEL)),
        'w_in': nrm(ks[3], (DEPTH, D_MODEL, IN_WIDTH), D_MODEL ** -0.5),
        'hg_lb_logits': nrm(ks[4], (DEPTH + 1, HG_QK), 1.0),
        'hg_out_norm_w': gain(ks[5], (DEPTH, HG_DV)),
        'nsa_q_norm_w': gain(ks[6], (DEPTH, NSA_HD)),
        'nsa_k_norm_w': gain(ks[7], (DEPTH, NSA_BRANCHES, NSA_HD)),
        'cmp_pe_k': nrm(ks[8], (DEPTH, CMP_BLOCK, NSA_HD), 0.1),
        'cmp_pe_v': nrm(ks[9], (DEPTH, CMP_BLOCK, NSA_HD), 0.1),
        'cmp_w1_k': nrm(ks[10], (DEPTH, CMP_BLOCK * NSA_HD, CMP_HIDDEN), (CMP_BLOCK * NSA_HD) ** -0.5),
        'cmp_w2_k': nrm(ks[11], (DEPTH, CMP_HIDDEN, NSA_HD), CMP_HIDDEN ** -0.5),
        'cmp_w1_v': nrm(ks[12], (DEPTH, CMP_BLOCK * NSA_HD, CMP_HIDDEN), (CMP_BLOCK * NSA_HD) ** -0.5),
        'cmp_w2_v': nrm(ks[13], (DEPTH, CMP_HIDDEN, NSA_HD), CMP_HIDDEN ** -0.5),
        'nsa_out_norm_w': gain(ks[14], (DEPTH, NSA_HD)),
        'w_out': nrm(ks[15], (DEPTH, MIX_WIDTH, D_MODEL), MIX_WIDTH ** -0.5),
        'norm2_w': gain(ks[16], (DEPTH, D_MODEL)),
        'peer_w_q': nrm(ks[17], (DEPTH, D_MODEL, PEER_HEADS * PEER_DK), D_MODEL ** -0.5),
        'peer_sub_keys': nrm(ks[18], (DEPTH, 2, PEER_NKEYS, PEER_DK // 2), (PEER_DK // 2) ** -0.5),
        'peer_u': nrm(ks[19], (DEPTH, PEER_EXPERTS, D_MODEL), D_MODEL ** -0.5),
        'peer_v': nrm(ks[20], (DEPTH, PEER_EXPERTS, D_MODEL), PEER_HEADS ** -0.5),
    }


def reference(x, positions, norm1_w, w_in, hg_lb_logits, hg_out_norm_w, nsa_q_norm_w, nsa_k_norm_w,
              cmp_pe_k, cmp_pe_v, cmp_w1_k, cmp_w2_k, cmp_w1_v, cmp_w2_v, nsa_out_norm_w, w_out,
              norm2_w, peer_w_q, peer_sub_keys, peer_u, peer_v):
    lower_bounds = jnp.cumsum(jax.nn.softmax(hg_lb_logits.astype(jnp.float32), axis=0), axis=0)
    split_at = [int(v) for v in np.cumsum(IN_SEGMENTS)[:-1]]
    h = x.astype(jnp.float32)
    for l in range(DEPTH):
        a = rms_norm(h, norm1_w[l])
        (hg_q, hg_f, hg_i, hg_g, n_q, n_kc, n_vc, n_ks, n_vs, n_kw, n_vw, n_gate) = jnp.split(a @ w_in[l], split_at, axis=-1)
        y_hg = hgrn2_mixer(hg_q, hg_f, hg_i, hg_g, lower_bounds[l], hg_out_norm_w[l])
        y_nsa = nsa_mixer(n_q, n_kc, n_vc, n_ks, n_vs, n_kw, n_vw, n_gate, positions,
                          nsa_q_norm_w[l], nsa_k_norm_w[l], cmp_pe_k[l], cmp_pe_v[l],
                          cmp_w1_k[l], cmp_w2_k[l], cmp_w1_v[l], cmp_w2_v[l], nsa_out_norm_w[l])
        h = h + jnp.concatenate([y_hg, y_nsa], axis=-1) @ w_out[l]
        h = h + peer_ffn(rms_norm(h, norm2_w[l]), peer_w_q[l], peer_sub_keys[l], peer_u[l], peer_v[l])
    return h.astype(x.dtype)
```

```cpp
#include <hip/hip_runtime.h>
#include <cstdio>
#ifndef STOP_AFTER
#define STOP_AFTER 99
#endif

typedef unsigned short bf16_t;
typedef short bf16x8 __attribute__((ext_vector_type(8)));
typedef short bf16x4 __attribute__((ext_vector_type(4)));
typedef float f32x2 __attribute__((ext_vector_type(2)));
typedef float f32x4 __attribute__((ext_vector_type(4)));
typedef float f32x16 __attribute__((ext_vector_type(16)));
typedef unsigned u32x2 __attribute__((ext_vector_type(2)));
typedef int i32x4 __attribute__((ext_vector_type(4)));
typedef unsigned u32x4 __attribute__((ext_vector_type(4)));
#define LAS __attribute__((address_space(3)))
#define DEV __device__ __forceinline__

constexpr int T_TOK = 65536, DM = 1024, SEQ = 2048, NB = 32;
constexpr int NPROJ = 3584;
constexpr int C_HQ = 0, C_HF = 512, C_HI = 1024, C_HG = 1536, C_NQ = 2048, C_KC = 2560, C_VC = 2688, C_KS = 2816, C_VS = 2944,
              C_KW = 3072, C_VW = 3200, C_GATE = 3328;
constexpr int LDS_BYTES = 147456;

constexpr size_t WS_BAR  = 0;
constexpr size_t WS_SMALL= 65536;
constexpr size_t WS_WIN  = 262144;
constexpr size_t WS_WOUT = WS_WIN  + (size_t)3584 * 1024 * 2;
constexpr size_t WS_WQ   = WS_WOUT + (size_t)1024 * 1024 * 2;
constexpr size_t WS_W1   = WS_WQ   + (size_t)2048 * 1024 * 2;
constexpr size_t WS_W2   = WS_W1   + (size_t)2 * 256 * 2048 * 2;
constexpr size_t WS_SK   = WS_W2   + (size_t)2 * 256 * 256 * 2;
constexpr size_t WS_TABU = WS_SK   + (size_t)2 * 128 * 128 * 2;
constexpr size_t WS_TABV = WS_TABU + (size_t)16384 * 1024 * 2;
constexpr size_t WS_XN   = WS_TABV + (size_t)16384 * 1024 * 2;
constexpr size_t WS_PROJ = WS_XN   + (size_t)T_TOK * 1024 * 2;
constexpr size_t WS_OHG  = WS_PROJ + (size_t)T_TOK * NPROJ * 2;
constexpr size_t WS_H1   = WS_OHG  + (size_t)T_TOK * 512 * 2;
constexpr size_t WS_KC   = WS_H1   + (size_t)4 * 4096 * 256 * 2;
constexpr size_t WS_END  = WS_KC   + (size_t)4 * 4096 * 64 * 4;
constexpr size_t WS_Q    = WS_PROJ;
constexpr size_t WS_EIDX = WS_Q + (size_t)T_TOK * 2048 * 2;
constexpr size_t WS_GATE = WS_EIDX + (size_t)T_TOK * 128 * 4;
static_assert(WS_GATE + (size_t)T_TOK * 128 * 4 <= WS_OHG, "peer scratch must fit in the PROJ region");

DEV int opaque_tid() { int t = threadIdx.x; asm volatile("" : "+v"(t)); return t; }
DEV float bf2f(unsigned short v) { return __uint_as_float((unsigned)v << 16); }
DEV float bflo(unsigned w) { return __uint_as_float(w << 16); }
DEV float bfhi(unsigned w) { return __uint_as_float(w & 0xffff0000u); }
typedef __bf16 bf16v2_t __attribute__((ext_vector_type(2)));
DEV unsigned pack2(float lo, float hi) { bf16v2_t v; v[0] = (__bf16)lo; v[1] = (__bf16)hi; return __builtin_bit_cast(unsigned, v); }
DEV unsigned short f2bf(float f) { return __builtin_bit_cast(unsigned short, (__bf16)f); }
DEV float sigmoidf_(float x) { return 1.0f / (1.0f + __expf(-x)); }
DEV float gelu_tanh(float x) { const float u = 0.7978845608028654f * (x + 0.044715f * x * x * x); const float e = __expf(2.0f * u); return x * (1.0f - 1.0f / (e + 1.0f)); }
DEV float gelu_erf(float x) { return 0.5f * x * (1.0f + erff(x * 0.70710678118654752f)); }
DEV float wave_sum16(float v) { v += __shfl_xor(v, 1); v += __shfl_xor(v, 2); v += __shfl_xor(v, 4); v += __shfl_xor(v, 8); return v; }
DEV float wave_max16(float v) { v = fmaxf(v, __shfl_xor(v, 1)); v = fmaxf(v, __shfl_xor(v, 2)); v = fmaxf(v, __shfl_xor(v, 4)); v = fmaxf(v, __shfl_xor(v, 8)); return v; }
DEV float wave_sum64(float v) { v = wave_sum16(v); v += __shfl_xor(v, 16); v += __shfl_xor(v, 32); return v; }

#define XB_TMO      128
#define XB_XCNT(j)  (256  + 64 * (j))
#define XB_XSUB(j)  (1280 + 64 * (j))
#define XB_XGEN(j)  (2304 + 64 * (j))
#define XB_TOP      3328
#define XB_TOPGEN   3392
#define XCD_BAR_WORDS 3456
#define XB_SPIN_CAP (1u << 24)
DEV unsigned xb_ld(unsigned* p)              { return __hip_atomic_load(p, __ATOMIC_RELAXED, __HIP_MEMORY_SCOPE_AGENT); }
DEV unsigned xb_add(unsigned* p, unsigned v) { return __hip_atomic_fetch_add(p, v, __ATOMIC_RELAXED, __HIP_MEMORY_SCOPE_AGENT); }
DEV unsigned xb_xcc_id() { return (unsigned)__builtin_amdgcn_s_getreg((3 << 11) | 20) & 0xFu; }
#define XB_SPIN(cond, bar) do { unsigned _sp = 0; while (cond) { __builtin_amdgcn_s_sleep(1); \
    if ((++_sp & 255u) == 0u) { if (xb_ld(&(bar)[XB_TMO])) break; if (_sp > XB_SPIN_CAP) { xb_add(&(bar)[XB_TMO], 1u); break; } } } } while (0)
struct XcdBarrier { unsigned* bar; unsigned x; volatile LAS unsigned* st; };
DEV XcdBarrier xcd_barrier_post(unsigned* bar, volatile LAS unsigned* st) {
    XcdBarrier b; b.bar = bar; b.x = xb_xcc_id(); b.st = st;
    if (threadIdx.x == 0) (void)xb_add(&bar[XB_XCNT(b.x)], 1u);
    return b;
}
DEV void xcd_barrier_complete(unsigned* bar, unsigned x, unsigned& nloc, unsigned& nx) {
    const unsigned G = gridDim.x * gridDim.y * gridDim.z;
    unsigned sum, cnt, mine, sp = 0u;
    for (;;) {
        sum = 0u; cnt = 0u; mine = 0u;
#pragma unroll
        for (unsigned j = 0; j < 16; ++j) { const unsigned c = xb_ld(&bar[XB_XCNT(j)]); sum += c; cnt += (c > 0u) ? 1u : 0u; mine = (j == x) ? c : mine; }
        if (sum == G) break;
        __builtin_amdgcn_s_sleep(1);
        if ((++sp & 255u) == 0u) { if (xb_ld(&bar[XB_TMO])) break; if (sp > XB_SPIN_CAP) { xb_add(&bar[XB_TMO], 1u); break; } }
    }
    nloc = mine > 0u ? mine : 1u; nx = cnt > 0u ? cnt : 1u;
}
DEV void xcd_barrier(const XcdBarrier& b) {
    asm volatile("s_waitcnt vmcnt(0)" ::: "memory");
    __syncthreads();
    if (threadIdx.x == 0) {
        unsigned* bar = b.bar;
        __builtin_amdgcn_s_waitcnt(0);
        unsigned nloc = b.st[0], nx = b.st[1];
        if (nloc == 0u) { xcd_barrier_complete(bar, b.x, nloc, nx); b.st[0] = nloc; b.st[1] = nx; }
        const unsigned old = xb_add(&bar[XB_XSUB(b.x)], 1u);
        const unsigned gen = old / nloc;
        if (old + 1u == (gen + 1u) * nloc) {
            __builtin_amdgcn_fence(__ATOMIC_RELEASE, "agent");
            asm volatile("s_waitcnt vmcnt(0)" ::: "memory");
            const unsigned og = xb_add(&bar[XB_TOP], 1u);
            const unsigned tg = og / nx;
            if (og + 1u == (tg + 1u) * nx) xb_add(&bar[XB_TOPGEN], 1u);
            else XB_SPIN(xb_ld(&bar[XB_TOPGEN]) == tg, bar);
            __builtin_amdgcn_fence(__ATOMIC_ACQUIRE, "agent");
            xb_add(&bar[XB_XGEN(b.x)], 1u);
            asm volatile("s_waitcnt vmcnt(0)" ::: "memory");
        } else {
            XB_SPIN(xb_ld(&bar[XB_XGEN(b.x)]) == gen, bar);
            __builtin_amdgcn_fence(__ATOMIC_ACQUIRE, "agent");
            asm volatile("s_waitcnt vmcnt(0)" ::: "memory");
        }
    }
    __syncthreads();
}
namespace pg8 {
constexpr int BM = 256, BK = 64, HALF = 128, HTB = HALF * BK * 2, STAGE_BYTES = 8 * HTB, NXCD = 8, WGM = 8;
DEV int lds_byte(int r, int c) { const int st = (r >> 4) * 2 + (c >> 5), rr = r & 15, cc = c & 31, ob = rr * 64 + cc * 2; return st * 1024 + (ob ^ (((ob >> 9) & 1) << 5)); }
DEV void stage_rc(int b, int& R, int& C) { const int st = b / 1024, sb = b % 1024, swz = sb ^ (((sb >> 9) & 1) << 5); R = (st >> 1) * 16 + swz / 64; C = (st & 1) * 32 + (swz % 64) / 2; }
DEV int perm32(int rho) { const int n = rho >> 4, i = rho & 15; return 8 * (i >> 2) + 4 * n + (i & 3); }
struct Unit { int pm, pn; };
struct Gemm { int K; int lda, ldb; int kstepA, kstepB; };

struct StaticOrder {
    const bf16_t* A; const bf16_t* Bt; size_t tstepA, tstepB;
    int nM, nN, nwg, G, c;
    DEV void init(const bf16_t* A_, const bf16_t* Bt_, int lda, int ldb, int M, int N, int G_, int c_) { A = A_; Bt = Bt_; tstepA = (size_t)256 * lda * 2; tstepB = (size_t)256 * ldb * 2; nM = M / BM; nN = N / BM; nwg = nM * nN; G = G_; c = c_; }
    DEV bool next(int i, Unit& u) const {
        const long L = (long)i * G + c; if (L >= nwg) return false;
        int wgid = (int)L; { const int q = nwg / NXCD, r = nwg % NXCD, xcd = wgid % NXCD, off = wgid / NXCD; wgid = (xcd < r ? xcd * (q + 1) : r * (q + 1) + (xcd - r) * q) + off; }
        const int nig = WGM * nN, gid = wgid / nig, fm = gid * WGM, gsz = (nM - fm) < WGM ? (nM - fm) : WGM;
        u.pm = fm + ((wgid % nig) % gsz); u.pn = (wgid % nig) / gsz; return true;
    }
    DEV const char* a_base(const Unit& u) const { return (const char*)A + (size_t)u.pm * tstepA; }
    DEV const char* b_base(const Unit& u) const { return (const char*)Bt + (size_t)u.pn * tstepB; }
};

DEV unsigned cvt_pk_bf16(float lo, float hi) { return pack2(lo, hi); }

template <class Epi, class Sched>
DEV void gemm_phase(LAS unsigned char* lds, const Gemm g, const Sched& S, const Epi& E) {
    const int tid = opaque_tid(), wid = __builtin_amdgcn_readfirstlane(tid >> 6), lane = tid & 63, wr = wid >> 2, wc = wid & 3, fr = lane & 15, fq = lane >> 4;
    const int nt = g.K / BK;
    unsigned voffA[2], voffB[2];
#pragma unroll
    for (int i = 0; i < 2; ++i) { int R, C; stage_rc(tid * 16 + i * 8192, R, C); const int Rb = Epi::PERM ? ((R & ~31) + perm32(R & 31)) : R;
        voffA[i] = (unsigned)(R * g.lda + C) * 2u; voffB[i] = (unsigned)(Rb * g.ldb + C) * 2u; }
    const size_t kstepA = (size_t)g.kstepA, kstepB = (size_t)g.kstepB;
    const size_t hstepA = (size_t)HALF * g.lda * 2, hstepB = (size_t)HALF * g.ldb * 2;
    const unsigned ldsw = (unsigned)wid * 1024u;
    const int aoff = lds_byte(wr * 64 + fr, fq * 8), boff = lds_byte(wc * 32 + fr, fq * 8);
#define PG8_SA(b, h) (((b) * 2 + (h)) * HTB)
#define PG8_SB(b, h) ((4 + (b) * 2 + (h)) * HTB)
#define PG8_STAGE(bufoff, gbase, voff) do { _Pragma("unroll") for (int _i = 0; _i < 2; ++_i) \
        __builtin_amdgcn_global_load_lds((const unsigned*)((const char*)(gbase) + (voff)[_i]), (LAS unsigned*)(lds + (bufoff) + ldsw + _i * 8192), 16, 0, 0); } while (0)
#define PG8_LDA(dst, b, h) do { _Pragma("unroll") for (int m = 0; m < 4; ++m) _Pragma("unroll") for (int k = 0; k < 2; ++k) dst[m][k] = *(const LAS bf16x8*)(lds + PG8_SA(b, h) + aoff + m * 2048 + k * 1024); } while (0)
#define PG8_LDB(dst, b, h) do { _Pragma("unroll") for (int n = 0; n < 2; ++n) _Pragma("unroll") for (int k = 0; k < 2; ++k) dst[n][k] = *(const LAS bf16x8*)(lds + PG8_SB(b, h) + boff + n * 2048 + k * 1024); } while (0)
#define PG8_MMA(ai, bj, At, Bt) do { __builtin_amdgcn_s_setprio(1); _Pragma("unroll") for (int m = 0; m < 4; ++m) _Pragma("unroll") for (int n = 0; n < 2; ++n) _Pragma("unroll") for (int k = 0; k < 2; ++k) \
        acc[ai][bj][m][n] = __builtin_amdgcn_mfma_f32_16x16x32_bf16(Bt[n][k], At[m][k], acc[ai][bj][m][n], 0, 0, 0); __builtin_amdgcn_s_setprio(0); } while (0)
#define PG8_WAIT_V(n) asm volatile("s_waitcnt vmcnt(" #n ")" ::: "memory")
#define PG8_WAIT_L(n) asm volatile("s_waitcnt lgkmcnt(" #n ")" ::: "memory")
#define PG8_BAR __builtin_amdgcn_s_barrier()
#define PG8_SCHED __builtin_amdgcn_sched_barrier(0)
    Unit cur, nxt; int ui = 0;
    if (!S.next(0, cur)) return;
    f32x4 acc[2][2][4][2];
#pragma unroll
    for (int a = 0; a < 2; ++a)
#pragma unroll
        for (int b = 0; b < 2; ++b)
#pragma unroll
            for (int m = 0; m < 4; ++m)
#pragma unroll
                for (int n = 0; n < 2; ++n) acc[a][b][m][n] = (f32x4){0.f, 0.f, 0.f, 0.f};
    bf16x8 At[4][2], B0[2][2], B1[2][2];
    const char* cA = S.a_base(cur); const char* cB = S.b_base(cur);
    PG8_STAGE(PG8_SB(0, 0), cB, voffB); PG8_STAGE(PG8_SA(0, 0), cA, voffA); PG8_STAGE(PG8_SB(0, 1), cB + hstepB, voffB); PG8_STAGE(PG8_SA(0, 1), cA + hstepA, voffA);
    if (wr == 1) PG8_BAR;
    PG8_WAIT_V(4); PG8_BAR;
    PG8_STAGE(PG8_SB(1, 0), cB + kstepB, voffB); PG8_STAGE(PG8_SA(1, 0), cA + kstepA, voffA); PG8_STAGE(PG8_SB(1, 1), cB + hstepB + kstepB, voffB);
    PG8_WAIT_V(6); PG8_BAR;
    for (;;) {
        const bool has_next = S.next(ui + 1, nxt);
        const char* nA = has_next ? S.a_base(nxt) : cA; const char* nB = has_next ? S.b_base(nxt) : cB;
        for (int t = 0; t < nt; t += 2) {
            const bool last = (t == nt - 2);
            const char* a1 = cA + (size_t)(t + 1) * kstepA;
            const char* a2 = last ? nA : cA + (size_t)(t + 2) * kstepA; const char* b2 = last ? nB : cB + (size_t)(t + 2) * kstepB;
            const char* a3 = a2 + kstepA; const char* b3 = b2 + kstepB;
            PG8_LDB(B0, 0, 0); PG8_SCHED; PG8_LDA(At, 0, 0); PG8_STAGE(PG8_SA(1, 1), a1 + hstepA, voffA);
            PG8_WAIT_L(8); PG8_BAR; PG8_WAIT_L(0); PG8_MMA(0, 0, At, B0); PG8_BAR; PG8_SCHED;
            PG8_LDB(B1, 0, 1); PG8_STAGE(PG8_SB(0, 0), b2, voffB);
            PG8_BAR; PG8_WAIT_L(0); PG8_MMA(0, 1, At, B1); PG8_BAR;
            PG8_LDA(At, 0, 1); PG8_STAGE(PG8_SA(0, 0), a2, voffA);
            PG8_BAR; PG8_WAIT_L(0); PG8_MMA(1, 0, At, B0); PG8_BAR; PG8_SCHED;
            PG8_STAGE(PG8_SB(0, 1), b2 + hstepB, voffB);
            PG8_WAIT_V(6); PG8_BAR; PG8_MMA(1, 1, At, B1); PG8_BAR;
            PG8_LDB(B0, 1, 0); PG8_SCHED; PG8_LDA(At, 1, 0); PG8_STAGE(PG8_SA(0, 1), a2 + hstepA, voffA);
            PG8_WAIT_L(8); PG8_BAR; PG8_WAIT_L(0); PG8_MMA(0, 0, At, B0); PG8_BAR; PG8_SCHED;
            PG8_LDB(B1, 1, 1); PG8_STAGE(PG8_SB(1, 0), b3, voffB);
            PG8_BAR; PG8_WAIT_L(0); PG8_MMA(0, 1, At, B1); PG8_BAR;
            PG8_LDA(At, 1, 1); PG8_STAGE(PG8_SA(1, 0), a3, voffA);
            PG8_BAR; PG8_WAIT_L(0); PG8_MMA(1, 0, At, B0); PG8_BAR; PG8_SCHED;
            PG8_STAGE(PG8_SB(1, 1), b3 + hstepB, voffB);
            PG8_WAIT_V(6); PG8_BAR; PG8_MMA(1, 1, At, B1); PG8_BAR;
        }
        E(acc, cur, wr, wc, fr, fq);
        if (!has_next) break;
#pragma unroll
        for (int a = 0; a < 2; ++a)
#pragma unroll
            for (int b = 0; b < 2; ++b)
#pragma unroll
                for (int m = 0; m < 4; ++m)
#pragma unroll
                    for (int n = 0; n < 2; ++n) acc[a][b][m][n] = (f32x4){0.f, 0.f, 0.f, 0.f};
        cur = nxt; cA = nA; cB = nB; ++ui;
    }
    PG8_WAIT_V(0);
    if (wr == 0) PG8_BAR;
    PG8_BAR;
#undef PG8_SA
#undef PG8_SB
#undef PG8_STAGE
#undef PG8_LDA
#undef PG8_LDB
#undef PG8_MMA
#undef PG8_WAIT_V
#undef PG8_WAIT_L
#undef PG8_BAR
#undef PG8_SCHED
}

template <int ACT> struct EpiBf16 {
    static constexpr bool PERM = true;
    bf16_t* O; int ldc; const float* bias;
    bf16_t* O2; int unit_split;
    DEV void operator()(const f32x4 (&acc)[2][2][4][2], const Unit& u, int wr, int wc, int fr, int fq) const {
        const int row0 = u.pm * BM + wr * 64 + fr; const int col0 = u.pn * BM + wc * 32 + 8 * fq;
        f32x4 bv[2][2];
#pragma unroll
        for (int bj = 0; bj < 2; ++bj)
#pragma unroll
            for (int n = 0; n < 2; ++n) bv[bj][n] = bias ? *(const f32x4*)(bias + col0 + bj * HALF + 4 * n) : (f32x4){0.f, 0.f, 0.f, 0.f};
#pragma unroll
        for (int ai = 0; ai < 2; ++ai)
#pragma unroll
            for (int m = 0; m < 4; ++m) { bf16_t* rowp = O + (size_t)(row0 + ai * HALF + m * 16) * ldc + col0;
#pragma unroll
                for (int bj = 0; bj < 2; ++bj) { f32x4 v0 = acc[ai][bj][m][0] + bv[bj][0], v1 = acc[ai][bj][m][1] + bv[bj][1];
                    if (ACT == 1) {
#pragma unroll
                        for (int j = 0; j < 4; ++j) { v0[j] = gelu_tanh(v0[j]); v1[j] = gelu_tanh(v1[j]); } }
                    u32x4 w; w.x = cvt_pk_bf16(v0[0], v0[1]); w.y = cvt_pk_bf16(v0[2], v0[3]); w.z = cvt_pk_bf16(v1[0], v1[1]); w.w = cvt_pk_bf16(v1[2], v1[3]);
                    *(u32x4*)(rowp + bj * HALF) = w; } }
    }
};
struct EpiResF32 {
    static constexpr bool PERM = false;
    float* C; const float* res; int ldc;
    DEV void operator()(const f32x4 (&acc)[2][2][4][2], const Unit& u, int wr, int wc, int fr, int fq) const {
        const int row0 = u.pm * BM + wr * 64 + fr, col0 = u.pn * BM + wc * 32 + 4 * fq;
#pragma unroll
        for (int ai = 0; ai < 2; ++ai)
#pragma unroll
            for (int m = 0; m < 4; ++m) { const size_t off = (size_t)(row0 + ai * HALF + m * 16) * ldc + col0;
#pragma unroll
                for (int bj = 0; bj < 2; ++bj)
#pragma unroll
                    for (int n = 0; n < 2; ++n) { const f32x4 r = *(const f32x4*)(res + off + bj * HALF + n * 16); *(f32x4*)(C + off + bj * HALF + n * 16) = acc[ai][bj][m][n] + r; } }
    }
};
}
struct Params {
    const float* x; const int* pos; const float* norm1_w; const float* w_in; const float* lb_logits; const float* hg_onw;
    const float* q_nw; const float* k_nw; const float* pe_k; const float* pe_v; const float* w1_k; const float* w2_k; const float* w1_v; const float* w2_v;
    const float* nsa_onw; const float* w_out; const float* norm2_w; const float* w_q; const float* sub_keys; const float* tab_u; const float* tab_v;
    float* out; unsigned char* ws;
};

DEV void transpose_convert(const float* __restrict__ src, bf16_t* __restrict__ dst, int K, int N, int Npad, int Kdst, size_t gid, size_t gsz) {
    const size_t items = (size_t)Npad * (K / 8);
    for (size_t it = gid; it < items; it += gsz) {
        const int kq = (int)(it & 7), n = (int)((it >> 3) % Npad), ko = (int)((it >> 3) / Npad) * 8 + kq;
        float v[8];
#pragma unroll
        for (int i = 0; i < 8; ++i) v[i] = (n < N) ? src[(size_t)(ko * 8 + i) * N + n] : 0.f;
        u32x4 w; w.x = pack2(v[0], v[1]); w.y = pack2(v[2], v[3]); w.z = pack2(v[4], v[5]); w.w = pack2(v[6], v[7]);
        *(u32x4*)(dst + (size_t)n * Kdst + ko * 8) = w;
    }
}
DEV void convert_flat(const float* __restrict__ src, bf16_t* __restrict__ dst, size_t n, size_t gid, size_t gsz) {
    for (size_t i = gid; i < n / 8; i += gsz) {
        const f32x4 a = ((const f32x4*)src)[2 * i], b = ((const f32x4*)src)[2 * i + 1];
        u32x4 w; w.x = pack2(a.x, a.y); w.y = pack2(a.z, a.w); w.z = pack2(b.x, b.y); w.w = pack2(b.z, b.w);
        ((u32x4*)dst)[i] = w;
    }
}
DEV void rmsnorm_rows(const float* __restrict__ src, const float* __restrict__ w, bf16_t* __restrict__ dst, int nrows) {
    const int tid_ = opaque_tid(); const int lane = tid_ & 63, wave = tid_ >> 6;
    f32x4 wv[4];
#pragma unroll
    for (int i = 0; i < 4; ++i) wv[i] = *(const f32x4*)(w + i * 256 + lane * 4);
    for (int row = blockIdx.x * 8 + wave; row < nrows; row += gridDim.x * 8) {
        const float* p = src + (size_t)row * 1024;
        f32x4 v[4]; float ss = 0.f;
#pragma unroll
        for (int i = 0; i < 4; ++i) { v[i] = *(const f32x4*)(p + i * 256 + lane * 4); ss += v[i].x * v[i].x + v[i].y * v[i].y + v[i].z * v[i].z + v[i].w * v[i].w; }
        ss = wave_sum64(ss);
        const float rs = rsqrtf(ss * (1.0f / 1024.0f) + 1e-6f);
#pragma unroll
        for (int i = 0; i < 4; ++i) { const f32x4 o = v[i] * rs * wv[i]; u32x2 pk; pk.x = pack2(o.x, o.y); pk.y = pack2(o.z, o.w);
            *(u32x2*)(dst + (size_t)row * 1024 + i * 256 + lane * 4) = pk; }
    }
}

DEV void phase0_prep(const Params& p) {
    unsigned char* ws = p.ws;
    const size_t gsz = (size_t)gridDim.x * 512, gid = (size_t)blockIdx.x * 512 + opaque_tid();
    transpose_convert(p.w_in, (bf16_t*)(ws + WS_WIN), 1024, 3352, 3584, 1024, gid, gsz);
    transpose_convert(p.w_out, (bf16_t*)(ws + WS_WOUT), 1024, 1024, 1024, 1024, gid, gsz);
    transpose_convert(p.w_q, (bf16_t*)(ws + WS_WQ), 1024, 2048, 2048, 1024, gid, gsz);
    transpose_convert(p.w1_k, (bf16_t*)(ws + WS_W1), 2048, 256, 256, 2048, gid, gsz);
    transpose_convert(p.w1_v, (bf16_t*)(ws + WS_W1) + 256 * 2048, 2048, 256, 256, 2048, gid, gsz);
    transpose_convert(p.w2_k, (bf16_t*)(ws + WS_W2), 256, 64, 256, 256, gid, gsz);
    transpose_convert(p.w2_v, (bf16_t*)(ws + WS_W2) + 256 * 256, 256, 64, 256, 256, gid, gsz);
    convert_flat(p.sub_keys, (bf16_t*)(ws + WS_SK), (size_t)2 * 128 * 128, gid, gsz);
    convert_flat(p.tab_u, (bf16_t*)(ws + WS_TABU), (size_t)16384 * 1024, gid, gsz);
    convert_flat(p.tab_v, (bf16_t*)(ws + WS_TABV), (size_t)16384 * 1024, gid, gsz);
    float* small = (float*)(ws + WS_SMALL);
    if (gid < 512) { const float l0 = p.lb_logits[gid], l1 = p.lb_logits[512 + gid]; small[gid] = 1.0f / (1.0f + __expf(l1 - l0)); }
    for (size_t it = gid; it < (size_t)64 * 512; it += gsz) {
        const int n = (int)(it & 255), kv = (int)((it >> 8) & 1), kc = (int)(it >> 9);
        const float* pe = kv ? p.pe_v : p.pe_k; const float* w1 = kv ? p.w1_v : p.w1_k;
        float s = 0.f;
        for (int k = kc * 32; k < kc * 32 + 32; ++k) s += pe[k] * w1[(size_t)k * 256 + n];
        small[1024 + it] = s;
    }
    rmsnorm_rows(p.x, p.norm1_w, (bf16_t*)(ws + WS_XN), T_TOK);
}
DEV f32x16 mfma32(bf16x8 a, bf16x8 b, f32x16 c) { return __builtin_amdgcn_mfma_f32_32x32x16_bf16(a, b, c, 0, 0, 0); }
DEV f32x4  mfma16(bf16x8 a, bf16x8 b, f32x4 c)  { return __builtin_amdgcn_mfma_f32_16x16x32_bf16(a, b, c, 0, 0, 0); }

constexpr int HG_QT = 0, HG_KT = 8704, HG_VT = 18944, HG_QS = 24064, HG_KS = 32768, HG_P = 41472, HG_DEC = 44032, HG_TOT = 44544, HG_ST0 = 46592, HG_ST1 = 64000;
constexpr int HG_LDQ = 136, HG_LDK = 40;

DEV void hgrn_chain(const Params& p, LAS unsigned char* lds, int chain) {
    const int tid = opaque_tid(), lane = tid & 63, wave = __builtin_amdgcn_readfirstlane(tid >> 6);
    const int b = chain >> 3, h = (chain >> 1) & 3, vh = chain & 1;
    const bf16_t* proj = (const bf16_t*)(p.ws + WS_PROJ);
    bf16_t* ohg = (bf16_t*)(p.ws + WS_OHG);
    const float* lbp = (const float*)(p.ws + WS_SMALL);
    LAS bf16_t* Qt = (LAS bf16_t*)(lds + HG_QT); LAS bf16_t* Kt = (LAS bf16_t*)(lds + HG_KT); LAS bf16_t* Vt = (LAS bf16_t*)(lds + HG_VT);
    LAS bf16_t* Qs = (LAS bf16_t*)(lds + HG_QS); LAS bf16_t* Ks = (LAS bf16_t*)(lds + HG_KS); LAS bf16_t* Pm = (LAS bf16_t*)(lds + HG_P);
    LAS float* dec = (LAS float*)(lds + HG_DEC); LAS float* tot = (LAS float*)(lds + HG_TOT);
    for (int i = tid; i < (2 * 17408) / 4; i += 512) ((LAS unsigned*)(lds + HG_ST0))[i] = 0u;
    const int k = tid & 127, part = tid >> 7;
    const float lbk = lbp[h * 128 + k];
    const int vv = tid & 63, sp = tid >> 6;
    const int kb = wave >> 1, vb = wave & 1;
    const int l31 = lane & 31, l5 = lane >> 5;
    f32x16 S;
#pragma unroll
    for (int i = 0; i < 16; ++i) S[i] = 0.f;
    __syncthreads();
    for (int c = 0; c < 64; ++c) {
        const size_t tok0 = (size_t)b * SEQ + c * 32;
        LAS unsigned char* Scur = lds + ((c & 1) ? HG_ST1 : HG_ST0);
        LAS unsigned char* Snxt = lds + ((c & 1) ? HG_ST0 : HG_ST1);
        float g[8], kk[8], qv[8];
#pragma unroll
        for (int i = 0; i < 8; ++i) {
            const size_t row = (tok0 + part * 8 + i) * NPROJ;
            const float fr = bf2f(proj[row + C_HF + h * 128 + k]);
            qv[i] = bf2f(proj[row + C_HQ + h * 128 + k]);
            const float sg = sigmoidf_(fr);
            const float f = lbk + (1.0f - lbk) * sg;
            g[i] = __logf(f); kk[i] = (1.0f - lbk) * (1.0f - sg);
        }
        float vl[4];
#pragma unroll
        for (int i = 0; i < 4; ++i) vl[i] = bf2f(proj[(tok0 + sp * 4 + i) * NPROJ + C_HI + h * 128 + vh * 64 + vv]);
#pragma unroll
        for (int i = 1; i < 8; ++i) g[i] += g[i - 1];
        tot[part * 128 + k] = g[7];
        __syncthreads();
        const float t0 = tot[k], t1 = tot[128 + k], t2 = tot[256 + k], t3 = tot[384 + k];
        const float off = (part > 0 ? t0 : 0.f) + (part > 1 ? t1 : 0.f) + (part > 2 ? t2 : 0.f);
        const float bend = t0 + t1 + t2 + t3, b15 = t0 + t1;
        float ktv[8];
#pragma unroll
        for (int i = 0; i < 8; ++i) {
            const int t = part * 8 + i; const float bb = off + g[i];
            Qt[t * HG_LDQ + k] = f2bf(qv[i] * __expf(bb));
            ktv[i] = kk[i] * __expf(bend - bb);
            Qs[t * HG_LDQ + k] = f2bf(qv[i] * __expf(fminf(bb - b15, 80.f)));
            Ks[t * HG_LDQ + k] = f2bf(kk[i] * __expf(fminf(b15 - bb, 80.f)));
        }
        { u32x4 w; w.x = pack2(ktv[0], ktv[1]); w.y = pack2(ktv[2], ktv[3]); w.z = pack2(ktv[4], ktv[5]); w.w = pack2(ktv[6], ktv[7]);
          *(LAS u32x4*)(Kt + k * HG_LDK + part * 8) = w; }
        if (part == 0) dec[k] = __expf(bend);
        { u32x2 w; w.x = pack2(vl[0], vl[1]); w.y = pack2(vl[2], vl[3]); *(LAS u32x2*)(Vt + vv * HG_LDK + sp * 4) = w; }
        __syncthreads();
        if (wave < 4) {
            const int ti = wave >> 1, si = wave & 1, fr = lane & 15, fq = lane >> 4;
            f32x4 acc = {0.f, 0.f, 0.f, 0.f};
            if (!(ti == 0 && si == 1)) {
#pragma unroll
                for (int ks = 0; ks < 4; ++ks) {
                    const bf16x8 a = *(const LAS bf16x8*)(Qs + (16 * ti + fr) * HG_LDQ + 32 * ks + 8 * fq);
                    const bf16x8 bq = *(const LAS bf16x8*)(Ks + (16 * si + fr) * HG_LDQ + 32 * ks + 8 * fq);
                    acc = mfma16(a, bq, acc);
                }
            }
#pragma unroll
            for (int r = 0; r < 4; ++r) { const int t = 16 * ti + 4 * fq + r, s = 16 * si + fr; Pm[t * HG_LDK + s] = f2bf(s <= t ? acc[r] : 0.f); }
        }
        __syncthreads();
        if (wave < 2) {
            f32x16 o;
#pragma unroll
            for (int i = 0; i < 16; ++i) o[i] = 0.f;
#pragma unroll
            for (int ks = 0; ks < 8; ++ks) {
                const bf16x8 a = *(const LAS bf16x8*)(Qt + l31 * HG_LDQ + 16 * ks + 8 * l5);
                const bf16x8 bq = *(const LAS bf16x8*)((LAS bf16_t*)Scur + (32 * wave + l31) * HG_LDQ + 16 * ks + 8 * l5);
                o = mfma32(a, bq, o);
            }
#pragma unroll
            for (int st = 0; st < 2; ++st) {
                const bf16x8 a = *(const LAS bf16x8*)(Pm + l31 * HG_LDK + 16 * st + 8 * l5);
                const bf16x8 bq = *(const LAS bf16x8*)(Vt + (32 * wave + l31) * HG_LDK + 16 * st + 8 * l5);
                o = mfma32(a, bq, o);
            }
#pragma unroll
            for (int r = 0; r < 16; ++r) { const int t = (r & 3) + 8 * (r >> 2) + 4 * l5;
                ohg[(tok0 + t) * 512 + h * 128 + vh * 64 + 32 * wave + l31] = f2bf(o[r]); }
        }
#pragma unroll
        for (int r = 0; r < 16; ++r) S[r] *= dec[32 * kb + (r & 3) + 8 * (r >> 2) + 4 * l5];
#pragma unroll
        for (int st = 0; st < 2; ++st) {
            const bf16x8 a = *(const LAS bf16x8*)(Kt + (32 * kb + l31) * HG_LDK + 16 * st + 8 * l5);
            const bf16x8 bq = *(const LAS bf16x8*)(Vt + (32 * vb + l31) * HG_LDK + 16 * st + 8 * l5);
            S = mfma32(a, bq, S);
        }
#pragma unroll
        for (int gq = 0; gq < 4; ++gq) { u32x2 w; w.x = pack2(S[4 * gq], S[4 * gq + 1]); w.y = pack2(S[4 * gq + 2], S[4 * gq + 3]);
            *(LAS u32x2*)((LAS bf16_t*)Snxt + (32 * vb + l31) * HG_LDQ + 32 * kb + 8 * gq + 4 * l5) = w; }
        __syncthreads();
    }
}
constexpr size_t WS_ROPE = WS_END;
constexpr size_t WS_END2 = WS_ROPE + (size_t)T_TOK * 16 * 4;
__device__ const double ROPE_INV_REV[8] = {
    0.15915494309189535, 0.03086376340470123, 0.005985185712713705, 0.001160663641240061, 0.00022507907903927653, 4.364795279280289e-05, 8.464330808241401e-06, 1.6414262627950345e-06 };
DEV void rope_table(const Params& p) {
    float* rope = (float*)(p.ws + WS_ROPE);
    const size_t gsz = (size_t)gridDim.x * 512, gid = (size_t)blockIdx.x * 512 + opaque_tid();
    for (size_t it = gid; it < (size_t)T_TOK * 8; it += gsz) {
        const int tok = (int)(it >> 3), i = (int)(it & 7);
        double a = (double)p.pos[tok] * ROPE_INV_REV[i];
        a -= __builtin_rint(a);
        const float fr = (float)a;
        rope[(size_t)tok * 16 + i] = __builtin_amdgcn_cosf(fr);
        rope[(size_t)tok * 16 + 8 + i] = __builtin_amdgcn_sinf(fr);
    }
}
DEV void qk_prep(const Params& p) {
    bf16_t* proj = (bf16_t*)(p.ws + WS_PROJ);
    const float* rope = (const float*)(p.ws + WS_ROPE);
    const size_t gsz = (size_t)gridDim.x * 512, gid = (size_t)blockIdx.x * 512 + opaque_tid();
    for (size_t it = gid; it < (size_t)T_TOK * 12; it += gsz) {
        const int tok = (int)(it / 12), slot = (int)(it % 12);
        const int col = slot < 8 ? C_NQ + slot * 64 : (slot < 10 ? C_KS + (slot - 8) * 64 : C_KW + (slot - 10) * 64);
        const float* w = slot < 8 ? p.q_nw : (slot < 10 ? p.k_nw + 64 : p.k_nw + 128);
        bf16_t* ptr = proj + (size_t)tok * NPROJ + col;
        float y[64]; float ss = 0.f;
#pragma unroll
        for (int c = 0; c < 8; ++c) { const u32x4 v = *(const u32x4*)(ptr + c * 8);
#pragma unroll
            for (int j = 0; j < 4; ++j) { y[c * 8 + 2 * j] = bflo(v[j]); y[c * 8 + 2 * j + 1] = bfhi(v[j]); } }
#pragma unroll
        for (int d = 0; d < 64; ++d) ss += y[d] * y[d];
        const float rs = rsqrtf(ss * (1.0f / 64.0f) + 1e-6f) ;
        const float sc = slot < 8 ? 0.125f : 1.0f;
#pragma unroll
        for (int d = 0; d < 64; ++d) y[d] = y[d] * rs * w[d];
#pragma unroll
        for (int i = 0; i < 8; ++i) { const float cs = rope[(size_t)tok * 16 + i], sn = rope[(size_t)tok * 16 + 8 + i];
            const float x1 = y[i], x2 = y[8 + i]; y[i] = x1 * cs - x2 * sn; y[8 + i] = x2 * cs + x1 * sn; }
#pragma unroll
        for (int c = 0; c < 8; ++c) { u32x4 v;
#pragma unroll
            for (int j = 0; j < 4; ++j) v[j] = pack2(y[c * 8 + 2 * j] * sc, y[c * 8 + 2 * j + 1] * sc);
            *(u32x4*)(ptr + c * 8) = v; }
    }
}
DEV void hgrn_finalize(const Params& p) {
    const bf16_t* proj = (const bf16_t*)(p.ws + WS_PROJ); const bf16_t* ohg = (const bf16_t*)(p.ws + WS_OHG); bf16_t* Y = (bf16_t*)(p.ws + WS_XN);
    const int tid_ = opaque_tid(); const int lane = tid_ & 63, wave = tid_ >> 6;
    float w[8];
#pragma unroll
    for (int j = 0; j < 8; ++j) w[j] = p.hg_onw[(lane & 15) * 8 + j];
    for (int tok = blockIdx.x * 8 + wave; tok < T_TOK; tok += gridDim.x * 8) {
        const u32x4 ov = *(const u32x4*)(ohg + (size_t)tok * 512 + lane * 8);
        const u32x4 gv = *(const u32x4*)(proj + (size_t)tok * NPROJ + C_HG + lane * 8);
        float o[8], g[8]; float ss = 0.f;
#pragma unroll
        for (int j = 0; j < 4; ++j) { o[2 * j] = bflo(ov[j]); o[2 * j + 1] = bfhi(ov[j]); g[2 * j] = bflo(gv[j]); g[2 * j + 1] = bfhi(gv[j]); }
#pragma unroll
        for (int j = 0; j < 8; ++j) ss += o[j] * o[j];
        ss = wave_sum16(ss);
        const float rs = rsqrtf(ss * (1.0f / 128.0f) + 1e-6f);
        u32x4 out;
#pragma unroll
        for (int j = 0; j < 4; ++j) { const float a = o[2 * j] * rs * w[2 * j] * (g[2 * j] * sigmoidf_(g[2 * j])), bq = o[2 * j + 1] * rs * w[2 * j + 1] * (g[2 * j + 1] * sigmoidf_(g[2 * j + 1])); out[j] = pack2(a, bq); }
        *(u32x4*)(Y + (size_t)tok * 1024 + lane * 8) = out;
    }
}
constexpr int AT_K = 0, AT_VT = 18432, AT_P = 35840, AT_IMPA = 70656, AT_IMPB = 87040, AT_IMP = 103424, AT_SEL = 107520;
constexpr int AT_LDK = 72, AT_LDV = 136, AT_LDP = 136, AT_PW = 16 * 136;

DEV void attn_stage_kv(const bf16_t* __restrict__ proj, size_t rowbase, int colk, int colv, LAS bf16_t* K, LAS bf16_t* VT, int tid) {
    const int key = tid >> 3, ch = tid & 7;
    const bf16_t* src = proj + (rowbase + key) * NPROJ;
    const u32x4 kv = *(const u32x4*)(src + colk + 8 * ch);
    const u32x4 vv = *(const u32x4*)(src + colv + 8 * ch);
    *(LAS u32x4*)(K + key * AT_LDK + 8 * ch) = kv;
#pragma unroll
    for (int j = 0; j < 4; ++j) { VT[(8 * ch + 2 * j) * AT_LDV + key] = (bf16_t)(vv[j] & 0xffffu); VT[(8 * ch + 2 * j + 1) * AT_LDV + key] = (bf16_t)(vv[j] >> 16); }
}

template <int MODE>
DEV void attn_block(const bf16x8 (&qa)[2], LAS bf16_t* K, LAS bf16_t* VT, LAS bf16_t* Pw, int fr, int fq, int keybase, const int (&trow)[4], const unsigned (&rsel)[4], int jb,
                    float (&m)[4], float (&l)[4], f32x4 (&o)[4]) {
    f32x4 s[4];
#pragma unroll
    for (int kt = 0; kt < 4; ++kt) { s[kt] = (f32x4){0.f, 0.f, 0.f, 0.f};
#pragma unroll
        for (int ds = 0; ds < 2; ++ds) { const bf16x8 bk = *(const LAS bf16x8*)(K + (16 * kt + fr) * AT_LDK + 32 * ds + 8 * fq); s[kt] = mfma16(qa[ds], bk, s[kt]); } }
    float alpha[4];
#pragma unroll
    for (int j = 0; j < 4; ++j) {
        bool ok[4]; float mx = -1e30f;
#pragma unroll
        for (int kt = 0; kt < 4; ++kt) { const int key = keybase + 16 * kt + fr;
            ok[kt] = MODE == 0 ? (((rsel[j] >> jb) & 1u) && key <= trow[j]) : (key <= trow[j] && trow[j] - key < 512);
            mx = fmaxf(mx, ok[kt] ? s[kt][j] : -1e30f); }
        mx = wave_max16(mx);
        const float mnew = fmaxf(m[j], mx);
        alpha[j] = __expf(m[j] - mnew);
        float rs = 0.f;
#pragma unroll
        for (int kt = 0; kt < 4; ++kt) { const float pv = ok[kt] ? __expf(s[kt][j] - mnew) : 0.f; s[kt][j] = pv; rs += pv; }
        rs = wave_sum16(rs);
        l[j] = l[j] * alpha[j] + rs; m[j] = mnew;
    }
#pragma unroll
    for (int kt = 0; kt < 4; ++kt)
#pragma unroll
        for (int j = 0; j < 4; ++j) Pw[(4 * fq + j) * AT_LDP + 16 * kt + fr] = f2bf(s[kt][j]);
#pragma unroll
    for (int dt = 0; dt < 4; ++dt)
#pragma unroll
        for (int j = 0; j < 4; ++j) o[dt][j] *= alpha[j];
    asm volatile("s_waitcnt lgkmcnt(0)" ::: "memory");
#pragma unroll
    for (int ks = 0; ks < 2; ++ks) { const bf16x8 a = *(const LAS bf16x8*)(Pw + fr * AT_LDP + 32 * ks + 8 * fq);
#pragma unroll
        for (int dt = 0; dt < 4; ++dt) { const bf16x8 bv = *(const LAS bf16x8*)(VT + (16 * dt + fr) * AT_LDV + 32 * ks + 8 * fq); o[dt] = mfma16(a, bv, o[dt]); } }
}

DEV void attn_item(const Params& p, LAS unsigned char* lds, int b, int g, int tt) {
    const int tid = opaque_tid(), lane = tid & 63, wave = __builtin_amdgcn_readfirstlane(tid >> 6);
    const int r = wave >> 1, th = wave & 1, fr = lane & 15, fq = lane >> 4;
    const bf16_t* proj = (const bf16_t*)(p.ws + WS_PROJ);
    const float* kc = (const float*)(p.ws + WS_KC);
    const float* rope = (const float*)(p.ws + WS_ROPE);
    bf16_t* Y = (bf16_t*)(p.ws + WS_XN);
    LAS bf16_t* K = (LAS bf16_t*)(lds + AT_K); LAS bf16_t* VT = (LAS bf16_t*)(lds + AT_VT); LAS bf16_t* Pw = (LAS bf16_t*)(lds + AT_P) + wave * AT_PW;
    LAS float* impA = (LAS float*)(lds + AT_IMPA); LAS float* impB = (LAS float*)(lds + AT_IMPB); LAS float* IMP = (LAS float*)(lds + AT_IMP);
    LAS unsigned* SEL = (LAS unsigned*)(lds + AT_SEL);
    const int tok0 = tt * 32, cur = tok0 >> 6;
    const size_t tb = (size_t)b * SEQ;
    int trow[4];
#pragma unroll
    for (int j = 0; j < 4; ++j) trow[j] = tok0 + 16 * th + 4 * fq + j;
    bf16x8 qa[2];
#pragma unroll
    for (int ds = 0; ds < 2; ++ds) qa[ds] = *(const bf16x8*)(proj + (tb + tok0 + 16 * th + fr) * NPROJ + C_NQ + (g * 4 + r) * 64 + 32 * ds + 8 * fq);
    __syncthreads();
    {
        const int c = tid >> 2, qd = tid & 3, d0 = 16 * qd;
        const float* kr = kc + ((size_t)(0 * 2 + g) * 4096 + b * 128 + c) * 64 + d0;
        const float* vr = kc + ((size_t)(1 * 2 + g) * 4096 + b * 128 + c) * 64 + d0;
        float y[16], v[16]; float ss = 0.f;
#pragma unroll
        for (int q4 = 0; q4 < 4; ++q4) { const f32x4 a = *(const f32x4*)(kr + 4 * q4), bq = *(const f32x4*)(vr + 4 * q4);
#pragma unroll
            for (int e = 0; e < 4; ++e) { y[4 * q4 + e] = a[e]; v[4 * q4 + e] = bq[e]; ss += a[e] * a[e]; } }
        ss += __shfl_xor(ss, 1); ss += __shfl_xor(ss, 2);
        const float rs = rsqrtf(ss * (1.0f / 64.0f) + 1e-6f);
#pragma unroll
        for (int e = 0; e < 16; ++e) y[e] = y[e] * rs * p.k_nw[d0 + e];
        if (qd == 0) { const int cc = c < 127 ? c : 126; const float* rp = rope + (tb + 16 * cc + 31) * 16;
#pragma unroll
            for (int i = 0; i < 8; ++i) { const float cs = rp[i], sn = rp[8 + i], x1 = y[i], x2 = y[8 + i]; y[i] = x1 * cs - x2 * sn; y[8 + i] = x2 * cs + x1 * sn; } }
        const float z = (c == 127) ? 0.f : 1.f;
        u32x4 w0, w1;
#pragma unroll
        for (int e = 0; e < 4; ++e) { w0[e] = pack2(y[2 * e] * z, y[2 * e + 1] * z); w1[e] = pack2(y[8 + 2 * e] * z, y[8 + 2 * e + 1] * z); }
        *(LAS u32x4*)(K + c * AT_LDK + d0) = w0; *(LAS u32x4*)(K + c * AT_LDK + d0 + 8) = w1;
#pragma unroll
        for (int e = 0; e < 16; ++e) VT[(d0 + e) * AT_LDV + c] = f2bf(v[e] * z);
        if (tid < 33) SEL[tid] = 0u;
    }
    __syncthreads();
    f32x4 ocmp[4];
#pragma unroll
    for (int dt = 0; dt < 4; ++dt) ocmp[dt] = (f32x4){0.f, 0.f, 0.f, 0.f};
    {
        f32x4 s[8];
#pragma unroll
        for (int kt = 0; kt < 8; ++kt) { s[kt] = (f32x4){0.f, 0.f, 0.f, 0.f};
#pragma unroll
            for (int ds = 0; ds < 2; ++ds) { const bf16x8 bk = *(const LAS bf16x8*)(K + (16 * kt + fr) * AT_LDK + 32 * ds + 8 * fq); s[kt] = mfma16(qa[ds], bk, s[kt]); } }
#pragma unroll
        for (int j = 0; j < 4; ++j) {
            float mx = -1e30f;
#pragma unroll
            for (int kt = 0; kt < 8; ++kt) { const bool ok = 16 * (16 * kt + fr) + 31 <= trow[j]; mx = fmaxf(mx, ok ? s[kt][j] : -1e30f); }
            mx = wave_max16(mx);
            float rs = 0.f;
#pragma unroll
            for (int kt = 0; kt < 8; ++kt) { const bool ok = 16 * (16 * kt + fr) + 31 <= trow[j]; const float pv = ok ? __expf(s[kt][j] - mx) : 0.f; s[kt][j] = pv; rs += pv; }
            rs = wave_sum16(rs);
            const float inv = rs > 0.f ? 1.0f / rs : 0.f;
            const int tr = 16 * th + 4 * fq + j;
#pragma unroll
            for (int kt = 0; kt < 8; ++kt) {
                const float x = s[kt][j] * inv;
                Pw[(4 * fq + j) * AT_LDP + 16 * kt + fr] = f2bf(x);
                const int q4 = fr & 3, jblk = 4 * kt + (fr >> 2);
                float ysum = (q4 == 3) ? 0.5f * x : x;
                ysum += __shfl_xor(ysum, 1); ysum += __shfl_xor(ysum, 2);
                if (q4 == 0) impA[(r * 32 + tr) * 32 + jblk] = ysum;
                if (q4 == 3) impB[(r * 32 + tr) * 32 + ((jblk + 1) & 31)] = (jblk == 31) ? 0.f : 0.5f * x;
            }
        }
        asm volatile("s_waitcnt lgkmcnt(0)" ::: "memory");
#pragma unroll
        for (int ks = 0; ks < 4; ++ks) { const bf16x8 a = *(const LAS bf16x8*)(Pw + fr * AT_LDP + 32 * ks + 8 * fq);
#pragma unroll
            for (int dt = 0; dt < 4; ++dt) { const bf16x8 bv = *(const LAS bf16x8*)(VT + (16 * dt + fr) * AT_LDV + 32 * ks + 8 * fq); ocmp[dt] = mfma16(a, bv, ocmp[dt]); } }
    }
    __syncthreads();
    {
        const int tk = tid >> 4, j0 = (tid & 15) * 2;
#pragma unroll
        for (int jj = 0; jj < 2; ++jj) { float sacc = 0.f;
#pragma unroll
            for (int rr = 0; rr < 4; ++rr) sacc += impA[(rr * 32 + tk) * 32 + j0 + jj] + impB[(rr * 32 + tk) * 32 + j0 + jj];
            IMP[tk * 32 + j0 + jj] = sacc; }
    }
    __syncthreads();
    {
        const int tk = tid >> 4;
#pragma unroll
        for (int jj = 0; jj < 2; ++jj) {
            const int j = (tid & 15) * 2 + jj;
            const bool valid = j <= cur, forced = (j == 0) || (j == cur) || (j == cur - 1);
            bool sel = valid;
            if (valid && !forced) { const float v = IMP[tk * 32 + j]; int rank = 0;
                for (int j2 = 1; j2 <= cur - 2; ++j2) { const float v2 = IMP[tk * 32 + j2]; rank += (v2 > v || (v2 == v && j2 < j)) ? 1 : 0; }
                sel = rank < 13; }
            if (sel) { __hip_atomic_fetch_or(&SEL[tk], 1u << j, __ATOMIC_RELAXED, __HIP_MEMORY_SCOPE_WORKGROUP); __hip_atomic_fetch_or(&SEL[32], 1u << j, __ATOMIC_RELAXED, __HIP_MEMORY_SCOPE_WORKGROUP); }
        }
    }
    __syncthreads();
    const unsigned selU = SEL[32];
    unsigned rsel[4];
#pragma unroll
    for (int j = 0; j < 4; ++j) rsel[j] = SEL[16 * th + 4 * fq + j];
    float m2[4], l2[4]; f32x4 oslc[4];
#pragma unroll
    for (int j = 0; j < 4; ++j) { m2[j] = -1e30f; l2[j] = 0.f; }
#pragma unroll
    for (int dt = 0; dt < 4; ++dt) oslc[dt] = (f32x4){0.f, 0.f, 0.f, 0.f};
    for (int jb = 0; jb <= cur; ++jb) {
        if (!((selU >> jb) & 1u)) continue;
        __syncthreads();
        attn_stage_kv(proj, tb + 64 * jb, C_KS + g * 64, C_VS + g * 64, K, VT, tid);
        __syncthreads();
        attn_block<0>(qa, K, VT, Pw, fr, fq, 64 * jb, trow, rsel, jb, m2, l2, oslc);
    }
    float m3[4], l3[4]; f32x4 owin[4];
#pragma unroll
    for (int j = 0; j < 4; ++j) { m3[j] = -1e30f; l3[j] = 0.f; }
#pragma unroll
    for (int dt = 0; dt < 4; ++dt) owin[dt] = (f32x4){0.f, 0.f, 0.f, 0.f};
    const int jlo = (tok0 > 511 ? tok0 - 511 : 0) >> 6;
    for (int jb = jlo; jb <= cur; ++jb) {
        __syncthreads();
        attn_stage_kv(proj, tb + 64 * jb, C_KW + g * 64, C_VW + g * 64, K, VT, tid);
        __syncthreads();
        attn_block<1>(qa, K, VT, Pw, fr, fq, 64 * jb, trow, rsel, jb, m3, l3, owin);
    }
#pragma unroll
    for (int j = 0; j < 4; ++j) {
        const size_t row = tb + trow[j];
        const bf16_t* gp = proj + row * NPROJ + C_GATE + (g * 4 + r) * 3;
        const float gc = sigmoidf_(bf2f(gp[0])), gs = sigmoidf_(bf2f(gp[1])) / l2[j], gw = sigmoidf_(bf2f(gp[2])) / l3[j];
        float ov[4]; float ss = 0.f;
#pragma unroll
        for (int dt = 0; dt < 4; ++dt) { ov[dt] = gc * ocmp[dt][j] + gs * oslc[dt][j] + gw * owin[dt][j]; ss += ov[dt] * ov[dt]; }
        ss = wave_sum16(ss);
        const float rs = rsqrtf(ss * (1.0f / 64.0f) + 1e-6f);
#pragma unroll
        for (int dt = 0; dt < 4; ++dt) Y[row * 1024 + 512 + (g * 4 + r) * 64 + 16 * dt + fr] = f2bf(ov[dt] * rs * p.nsa_onw[16 * dt + fr]);
    }
}

DEV void phase_attention(const Params& p, LAS unsigned char* lds) {
    hgrn_finalize(p);
    const int G = gridDim.x;
    for (int q = blockIdx.x; q < 4096; q += G) {
        const int bg = q >> 6, tt = ((q & 63) + bg * 5) & 63;
        attn_item(p, lds, bg >> 1, bg & 1, tt);
    }
}
DEV void ce_desc(float& a, float& b) { const float hi = fmaxf(a, b), lo = fminf(a, b); a = hi; b = lo; }
DEV void ce_asc(float& a, float& b) { const float hi = fmaxf(a, b), lo = fminf(a, b); a = lo; b = hi; }
DEV void sort16_desc(float (&x)[16]) {
#pragma unroll
    for (int k = 2; k <= 16; k <<= 1)
#pragma unroll
        for (int j = k >> 1; j > 0; j >>= 1)
#pragma unroll
            for (int i = 0; i < 16; ++i) { const int l = i ^ j; if (l > i) { if ((i & k) == 0) ce_desc(x[i], x[l]); else ce_asc(x[i], x[l]); } }
}
DEV void merge16_desc(float (&a)[16], const float (&b)[16]) {
#pragma unroll
    for (int i = 0; i < 16; ++i) a[i] = fmaxf(a[i], b[15 - i]);
#pragma unroll
    for (int j = 8; j > 0; j >>= 1)
#pragma unroll
        for (int i = 0; i < 16; ++i) { const int l = i ^ j; if (l > i) ce_desc(a[i], a[l]); }
}
DEV void insert16_desc(float (&a)[16], float x) {
#pragma unroll
    for (int i = 0; i < 16; ++i) { const float hi = fmaxf(a[i], x); x = fminf(a[i], x); a[i] = hi; }
}
DEV float tagf(float v, unsigned mask, unsigned tag) { return __uint_as_float((__float_as_uint(v) & ~mask) | tag); }
DEV float untag(float v, unsigned mask) { return __uint_as_float(__float_as_uint(v) & ~mask); }

DEV void route_half(const bf16_t* __restrict__ qrow, const bf16_t* __restrict__ sk, int l31, int l5, float (&top)[16]) {
    f32x16 acc[4];
#pragma unroll
    for (int nt = 0; nt < 4; ++nt)
#pragma unroll
        for (int i = 0; i < 16; ++i) acc[nt][i] = 0.f;
#pragma unroll 2
    for (int ks = 0; ks < 8; ++ks) {
        const bf16x8 bq = *(const bf16x8*)(qrow + 16 * ks + 8 * l5);
#pragma unroll
        for (int nt = 0; nt < 4; ++nt) { const bf16x8 a = *(const bf16x8*)(sk + (size_t)(32 * nt + l31) * 128 + 16 * ks + 8 * l5); acc[nt] = mfma32(a, bq, acc[nt]); }
    }
    float cur[16];
#pragma unroll
    for (int nt = 0; nt < 4; ++nt) {
        float x[16];
#pragma unroll
        for (int i = 0; i < 16; ++i) x[i] = tagf(acc[nt][i], 127u, (unsigned)(32 * nt + (i & 3) + 8 * (i >> 2) + 4 * l5));
        sort16_desc(x);
        if (nt == 0) {
#pragma unroll
            for (int i = 0; i < 16; ++i) cur[i] = x[i];
        } else merge16_desc(cur, x);
    }
    float oth[16];
#pragma unroll
    for (int i = 0; i < 16; ++i) oth[i] = __shfl_xor(cur[i], 32);
    merge16_desc(cur, oth);
#pragma unroll
    for (int i = 0; i < 16; ++i) top[i] = cur[i];
}

DEV void phase_route(const Params& p, LAS unsigned char* lds) {
    const int tid = opaque_tid(), lane = tid & 63, wave = tid >> 6, l31 = lane & 31, l5 = lane >> 5;
    const bf16_t* Q = (const bf16_t*)(p.ws + WS_Q);
    const bf16_t* sk = (const bf16_t*)(p.ws + WS_SK);
    int* eidx = (int*)(p.ws + WS_EIDX); float* gate = (float*)(p.ws + WS_GATE);
    LAS float* lst = (LAS float*)lds + wave * 2048;
    for (int rg = blockIdx.x * 8 + wave; rg < T_TOK * 8 / 32; rg += gridDim.x * 8) {
        const size_t row = (size_t)rg * 32 + l31;
        float v1[16], v2[16];
        route_half(Q + row * 256, sk, l31, l5, v1);
#pragma unroll
        for (int i = 0; i < 16; ++i) asm volatile("" : "+v"(v1[i]));
        route_half(Q + row * 256 + 128, sk + 128 * 128, l31, l5, v2);
        float f1[16], f2[16];
#pragma unroll
        for (int i = 0; i < 16; ++i) { f1[i] = untag(v1[i], 127u); f2[i] = untag(v2[i], 127u); lst[i * 64 + lane] = v1[i]; lst[(16 + i) * 64 + lane] = v2[i]; }
        float c[16];
#pragma unroll
        for (int bq = 0; bq < 16; ++bq) c[bq] = tagf(f1[0] + f2[bq], 255u, (unsigned)bq);
#pragma unroll
        for (int a = 1; a < 16; ++a) {
            const int nb = 16 / (a + 1);
#pragma unroll
            for (int bq = 0; bq < nb; ++bq) insert16_desc(c, tagf(f1[a] + f2[bq], 255u, (unsigned)(a * 16 + bq)));
        }
        float s[16]; float mx = -1e30f, sum = 0.f;
#pragma unroll
        for (int i = 0; i < 16; ++i) { s[i] = untag(c[i], 255u); mx = fmaxf(mx, s[i]); }
#pragma unroll
        for (int i = 0; i < 16; ++i) { s[i] = __expf(s[i] - mx); sum += s[i]; }
        const float inv = 1.0f / sum;
        asm volatile("s_waitcnt lgkmcnt(0)" ::: "memory");
        if (l5 == 0) {
#pragma unroll
            for (int q4 = 0; q4 < 4; ++q4) { int e[4];
#pragma unroll
                for (int i = 0; i < 4; ++i) { const unsigned tg = __float_as_uint(c[4 * q4 + i]) & 255u; const unsigned a = tg >> 4, bq = tg & 15u;
                    const unsigned i1 = __float_as_uint(lst[a * 64 + lane]) & 127u, i2 = __float_as_uint(lst[(16 + bq) * 64 + lane]) & 127u; e[i] = (int)(i1 * 128u + i2); }
                { i32x4 ev; ev[0] = e[0]; ev[1] = e[1]; ev[2] = e[2]; ev[3] = e[3]; *(i32x4*)(eidx + row * 16 + 4 * q4) = ev; } }
        } else {
#pragma unroll
            for (int q4 = 0; q4 < 4; ++q4) { f32x4 gq;
#pragma unroll
                for (int i = 0; i < 4; ++i) gq[i] = s[4 * q4 + i] * inv;
                *(f32x4*)(gate + row * 16 + 4 * q4) = gq; }
        }
        asm volatile("s_waitcnt lgkmcnt(0)" ::: "memory");
    }
}

DEV void phase_experts(const Params& p) {
    const int tid_ = opaque_tid(); const int lane = tid_ & 63, wave = tid_ >> 6;
    const bf16_t* HN = (const bf16_t*)(p.ws + WS_XN);
    const bf16_t* TU = (const bf16_t*)(p.ws + WS_TABU); const bf16_t* TV = (const bf16_t*)(p.ws + WS_TABV);
    const int* eidx = (const int*)(p.ws + WS_EIDX); const float* gate = (const float*)(p.ws + WS_GATE);
    for (int tok = blockIdx.x * 8 + wave; tok < T_TOK; tok += gridDim.x * 8) {
        float xf[16];
        { const u32x4 a = *(const u32x4*)(HN + (size_t)tok * 1024 + lane * 16), bq = *(const u32x4*)(HN + (size_t)tok * 1024 + lane * 16 + 8);
#pragma unroll
          for (int j = 0; j < 4; ++j) { xf[2 * j] = bflo(a[j]); xf[2 * j + 1] = bfhi(a[j]); xf[8 + 2 * j] = bflo(bq[j]); xf[8 + 2 * j + 1] = bfhi(bq[j]); } }
        float acc[16];
#pragma unroll
        for (int j = 0; j < 16; ++j) acc[j] = 0.f;
        for (int grp = 0; grp < 16; ++grp) {
            int e[8]; float gt[8];
#pragma unroll
            for (int i = 0; i < 8; ++i) { e[i] = __builtin_amdgcn_readfirstlane(eidx[(size_t)tok * 128 + grp * 8 + i]); gt[i] = gate[(size_t)tok * 128 + grp * 8 + i]; }
            u32x4 ua[8], ub[8];
#pragma unroll
            for (int i = 0; i < 8; ++i) { const bf16_t* rp = TU + (size_t)e[i] * 1024 + lane * 16; ua[i] = *(const u32x4*)rp; ub[i] = *(const u32x4*)(rp + 8); }
            float act[8];
#pragma unroll
            for (int i = 0; i < 8; ++i) { float s = 0.f;
#pragma unroll
                for (int j = 0; j < 4; ++j) { s += bflo(ua[i][j]) * xf[2 * j] + bfhi(ua[i][j]) * xf[2 * j + 1]; s += bflo(ub[i][j]) * xf[8 + 2 * j] + bfhi(ub[i][j]) * xf[8 + 2 * j + 1]; }
                s = wave_sum64(s);
                act[i] = gelu_erf(s) * gt[i]; }
#pragma unroll
            for (int i = 0; i < 8; ++i) { const bf16_t* rp = TV + (size_t)e[i] * 1024 + lane * 16; ua[i] = *(const u32x4*)rp; ub[i] = *(const u32x4*)(rp + 8); }
#pragma unroll
            for (int i = 0; i < 8; ++i)
#pragma unroll
                for (int j = 0; j < 4; ++j) { acc[2 * j] += act[i] * bflo(ua[i][j]); acc[2 * j + 1] += act[i] * bfhi(ua[i][j]); acc[8 + 2 * j] += act[i] * bflo(ub[i][j]); acc[8 + 2 * j + 1] += act[i] * bfhi(ub[i][j]); }
        }
        float* op = p.out + (size_t)tok * 1024 + lane * 16;
#pragma unroll
        for (int q4 = 0; q4 < 4; ++q4) { f32x4 hv = *(const f32x4*)(op + 4 * q4);
#pragma unroll
            for (int j = 0; j < 4; ++j) hv[j] += acc[4 * q4 + j];
            *(f32x4*)(op + 4 * q4) = hv; }
    }
}
struct CmpOrder1 {
    const bf16_t* proj; const bf16_t* w1t; int G, c;
    DEV bool next(int i, pg8::Unit& u) const { const int L = i * G + c; if (L >= 64) return false; u.pm = L; u.pn = 0; return true; }
    DEV const char* a_base(const pg8::Unit& u) const { const int kv = u.pm >> 5, g = (u.pm >> 4) & 1, pm = u.pm & 15;
        return (const char*)(proj + (kv ? C_VC : C_KC) + g * 64) + (size_t)pm * 256 * (16 * NPROJ) * 2; }
    DEV const char* b_base(const pg8::Unit& u) const { return (const char*)(w1t + (size_t)(u.pm >> 5) * 256 * 2048); }
};
struct EpiCmp1 {
    static constexpr bool PERM = true;
    bf16_t* H1; const float* bias;
    DEV void operator()(const f32x4 (&acc)[2][2][4][2], const pg8::Unit& u, int wr, int wc, int fr, int fq) const {
        const int row0 = u.pm * 256 + wr * 64 + fr; const int col0 = wc * 32 + 8 * fq; const float* bp = bias + (u.pm >> 5) * 256;
#pragma unroll
        for (int ai = 0; ai < 2; ++ai)
#pragma unroll
            for (int m = 0; m < 4; ++m) { bf16_t* rowp = H1 + (size_t)(row0 + ai * 128 + m * 16) * 256 + col0;
#pragma unroll
                for (int bj = 0; bj < 2; ++bj) { f32x4 v0 = acc[ai][bj][m][0] + *(const f32x4*)(bp + col0 + bj * 128), v1 = acc[ai][bj][m][1] + *(const f32x4*)(bp + col0 + bj * 128 + 4);
#pragma unroll
                    for (int j = 0; j < 4; ++j) { v0[j] = gelu_tanh(v0[j]); v1[j] = gelu_tanh(v1[j]); }
                    u32x4 w; w.x = pack2(v0[0], v0[1]); w.y = pack2(v0[2], v0[3]); w.z = pack2(v1[0], v1[1]); w.w = pack2(v1[2], v1[3]);
                    *(u32x4*)(rowp + bj * 128) = w; } }
    }
};
struct CmpOrder2 {
    const bf16_t* h1; const bf16_t* w2t; int G, c;
    DEV bool next(int i, pg8::Unit& u) const { const int L = i * G + c; if (L >= 64) return false; u.pm = L; u.pn = 0; return true; }
    DEV const char* a_base(const pg8::Unit& u) const { return (const char*)(h1 + (size_t)u.pm * 256 * 256); }
    DEV const char* b_base(const pg8::Unit& u) const { return (const char*)(w2t + (size_t)(u.pm >> 5) * 256 * 256); }
};
struct EpiCmp2 {
    static constexpr bool PERM = false;
    float* KC;
    DEV void operator()(const f32x4 (&acc)[2][2][4][2], const pg8::Unit& u, int wr, int wc, int fr, int fq) const {
        if (wc >= 2) return;
        const int row0 = u.pm * 256 + wr * 64 + fr, col0 = wc * 32 + 4 * fq;
#pragma unroll
        for (int ai = 0; ai < 2; ++ai)
#pragma unroll
            for (int m = 0; m < 4; ++m)
#pragma unroll
                for (int n = 0; n < 2; ++n) *(f32x4*)(KC + (size_t)(row0 + ai * 128 + m * 16) * 64 + col0 + n * 16) = acc[ai][0][m][n];
    }
};


DEV void diag_dump(float* out, const bf16_t* src, int ld, int coloff, int ncols, int outcol0) {
    const size_t gsz = (size_t)gridDim.x * 512, gid = (size_t)blockIdx.x * 512 + threadIdx.x;
    for (size_t it = gid; it < (size_t)T_TOK * ncols; it += gsz) { const size_t t = it / ncols; const int c = (int)(it % ncols); out[t * 1024 + outcol0 + c] = bf2f(src[t * ld + coloff + c]); }
}
DEV void diag_zero(float* out) {
    const size_t gsz = (size_t)gridDim.x * 512, gid = (size_t)blockIdx.x * 512 + threadIdx.x;
    for (size_t it = gid; it < (size_t)T_TOK * 1024; it += gsz) out[it] = 0.f;
}
__global__ void __launch_bounds__(512) fwd_megakernel(Params p) {
    extern __shared__ __attribute__((aligned(16))) unsigned char lds_raw[];
    LAS unsigned char* lds = (LAS unsigned char*)lds_raw;
    const int tid = threadIdx.x;
    volatile LAS unsigned* st = (volatile LAS unsigned*)(lds + LDS_BYTES - 16);
    if (tid < 4) st[tid] = 0u;
    __syncthreads();
    XcdBarrier bar = xcd_barrier_post((unsigned*)(p.ws + WS_BAR), st);
    unsigned char* ws = p.ws;
    const int G = gridDim.x, bx = blockIdx.x;
    bf16_t* proj = (bf16_t*)(ws + WS_PROJ);

    phase0_prep(p);
    rope_table(p);
    xcd_barrier(bar);
    { pg8::Gemm g{1024, 1024, 1024, 128, 128}; pg8::StaticOrder S; S.init((const bf16_t*)(ws + WS_XN), (const bf16_t*)(ws + WS_WIN), 1024, 1024, T_TOK, NPROJ, G, bx);
      pg8::EpiBf16<0> E{proj, NPROJ, nullptr, nullptr, 0};
      pg8::gemm_phase(lds, g, S, E); }
    xcd_barrier(bar);
    if (STOP_AFTER == 1) { diag_dump(p.out, proj, NPROJ, 0, 1024, 0); return; }
    for (int ch = bx; ch < 256; ch += G) hgrn_chain(p, lds, ch);
    qk_prep(p);
    if (bx == G - 1) { const int t2 = opaque_tid(); float* small = (float*)(ws + WS_SMALL); float s = 0.f; for (int kc = 0; kc < 64; ++kc) s += small[1024 + kc * 512 + t2]; small[512 + t2] = s; }
    xcd_barrier(bar);
    if (STOP_AFTER == 2) { diag_dump(p.out, (const bf16_t*)(ws + WS_OHG), 512, 0, 512, 0); diag_dump(p.out, proj, NPROJ, C_NQ, 512, 512); return; }
    if (STOP_AFTER == 23) { diag_dump(p.out, (const bf16_t*)(ws + WS_OHG), 512, 0, 512, 0); diag_dump(p.out, proj, NPROJ, C_HI, 512, 512); return; }
    if (STOP_AFTER == 24) { diag_dump(p.out, proj, NPROJ, C_NQ, 512, 0); diag_dump(p.out, proj, NPROJ, C_HG, 512, 512); return; }
    if (STOP_AFTER == 22) { diag_dump(p.out, proj, NPROJ, C_KS, 512, 0); diag_dump(p.out, proj, NPROJ, C_HI, 512, 512); return; }
    { pg8::Gemm g{2048, 16 * NPROJ, 2048, NPROJ * 2, 128}; CmpOrder1 S{proj, (const bf16_t*)(ws + WS_W1), G, bx};
      EpiCmp1 E{(bf16_t*)(ws + WS_H1), (const float*)(ws + WS_SMALL) + 512};
      pg8::gemm_phase(lds, g, S, E); }
    xcd_barrier(bar);
    { pg8::Gemm g{256, 256, 256, 128, 128}; CmpOrder2 S{(const bf16_t*)(ws + WS_H1), (const bf16_t*)(ws + WS_W2), G, bx};
      EpiCmp2 E{(float*)(ws + WS_KC)};
      pg8::gemm_phase(lds, g, S, E); }
    xcd_barrier(bar);
    if (STOP_AFTER == 4) { diag_zero(p.out); __syncthreads(); const size_t gsz = (size_t)gridDim.x * 512, gid = (size_t)blockIdx.x * 512 + threadIdx.x; const float* kcq = (const float*)(ws + WS_KC);
        for (size_t it = gid; it < (size_t)16384 * 64; it += gsz) { const int row = (int)(it >> 6); if ((row & 127) != 127) p.out[it] = kcq[it]; } return; }
    phase_attention(p, lds);
    xcd_barrier(bar);
    if (STOP_AFTER == 5) { diag_dump(p.out, (const bf16_t*)(ws + WS_XN), 1024, 0, 1024, 0); return; }
    { pg8::Gemm g{1024, 1024, 1024, 128, 128}; pg8::StaticOrder S; S.init((const bf16_t*)(ws + WS_XN), (const bf16_t*)(ws + WS_WOUT), 1024, 1024, T_TOK, 1024, G, bx);
      pg8::EpiResF32 E{p.out, p.x, 1024};
      pg8::gemm_phase(lds, g, S, E); }
    if (STOP_AFTER == 6) return;
    xcd_barrier(bar);
    rmsnorm_rows(p.out, p.norm2_w, (bf16_t*)(ws + WS_XN), T_TOK);
    xcd_barrier(bar);
    { pg8::Gemm g{1024, 1024, 1024, 128, 128}; pg8::StaticOrder S; S.init((const bf16_t*)(ws + WS_XN), (const bf16_t*)(ws + WS_WQ), 1024, 1024, T_TOK, 2048, G, bx);
      pg8::EpiBf16<0> E{(bf16_t*)(ws + WS_Q), 2048, nullptr, nullptr, 0};
      pg8::gemm_phase(lds, g, S, E); }
    xcd_barrier(bar);
    phase_route(p, lds);
    xcd_barrier(bar);
    phase_experts(p);
}

extern "C" void kernel_launch(void* const* d_in, const int* in_sizes, int n_in, void* d_out, int out_size,
                              void* d_ws, size_t ws_size, hipStream_t stream) {
    static int grid_blocks = 0;
    if (!grid_blocks) {
        int dev = 0, cus = 0, per_cu = 0;
        (void)hipGetDevice(&dev);
        (void)hipDeviceGetAttribute(&cus, hipDeviceAttributeMultiprocessorCount, dev);
        (void)hipFuncSetAttribute((const void*)fwd_megakernel, hipFuncAttributeMaxDynamicSharedMemorySize, LDS_BYTES);
        (void)hipOccupancyMaxActiveBlocksPerMultiprocessor(&per_cu, (const void*)fwd_megakernel, 512, LDS_BYTES);
        if (per_cu < 1) { fprintf(stderr, "occupancy query says %d blocks/CU\n", per_cu); per_cu = 1; }
        if (per_cu > 1) per_cu = 1;
        grid_blocks = cus * per_cu;
        if (ws_size < WS_END2 || n_in != 21) { fprintf(stderr, "kernel_launch: ws %zu < %zu or n_in %d\n", ws_size, (size_t)WS_END2, n_in); grid_blocks = -1; }
    }
    if (grid_blocks < 0) return;
    (void)hipMemsetAsync((char*)d_ws + WS_BAR, 0, XCD_BAR_WORDS * 4, stream);
    Params p{};
    p.x = (const float*)d_in[0]; p.pos = (const int*)d_in[1]; p.norm1_w = (const float*)d_in[2]; p.w_in = (const float*)d_in[3]; p.lb_logits = (const float*)d_in[4];
    p.hg_onw = (const float*)d_in[5]; p.q_nw = (const float*)d_in[6]; p.k_nw = (const float*)d_in[7]; p.pe_k = (const float*)d_in[8]; p.pe_v = (const float*)d_in[9];
    p.w1_k = (const float*)d_in[10]; p.w2_k = (const float*)d_in[11]; p.w1_v = (const float*)d_in[12]; p.w2_v = (const float*)d_in[13]; p.nsa_onw = (const float*)d_in[14];
    p.w_out = (const float*)d_in[15]; p.norm2_w = (const float*)d_in[16]; p.w_q = (const float*)d_in[17]; p.sub_keys = (const float*)d_in[18]; p.tab_u = (const float*)d_in[19]; p.tab_v = (const float*)d_in[20];
    p.out = (float*)d_out; p.ws = (unsigned char*)d_ws;
    void* args[] = {&p};
    hipError_t e = hipLaunchCooperativeKernel((const void*)fwd_megakernel, dim3(grid_blocks), dim3(512), args, LDS_BYTES, stream);
    if (e != hipSuccess) fprintf(stderr, "cooperative launch failed: %s (grid %d)\n", hipGetErrorString(e), grid_blocks);
}
```
